# Optimizing an MI355X kernel written in HIP

```python
import jax, jax.numpy as jnp
from jax import lax
import numpy as np

D_MODEL = 1024
BATCH = 32
SEQ = 2048
DEPTH = 1

D_RNN = 1024
N_LRU_BLOCKS = 16
LRU_BLOCK = D_RNN // N_LRU_BLOCKS
CONV_WIDTH = 4
LRU_C = 8.0
ATTN_GROUPS = ((128, 1), (512, 4), (2048, 16))
N_GROUPS = len(ATTN_GROUPS)
HEADS_PER_GROUP = 4
HEAD_DIM = 128
ATTN_WIDTH = N_GROUPS * HEADS_PER_GROUP * HEAD_DIM
ATTN_OUT_WIDTH = HEADS_PER_GROUP * HEAD_DIM
ROPE_DIM = HEAD_DIM // 4
ROPE_THETA = 500000.0
Q_BLOCK = 128
N_BRANCHES = 2
D_FF = ((8 * D_MODEL // 3 + 255) // 256) * 256
IN_WIDTH = 2 * D_RNN + 3 * ATTN_WIDTH + N_BRANCHES * D_MODEL
EPS = 1e-6
NEG = -1e30

kernel_name = "hawk_dilated_attn_hybrid_block"


def rms_norm(x, g):
    xf = x.astype(jnp.float32)
    y = xf * lax.rsqrt(jnp.mean(xf * xf, axis=-1, keepdims=True) + EPS)
    return (y * g.astype(jnp.float32)).astype(x.dtype)


def causal_depthwise_conv(x, w, b):
    y = lax.conv_general_dilated(
        x, w[:, None, :].astype(x.dtype), window_strides=(1,),
        padding=((CONV_WIDTH - 1, 0),), dimension_numbers=('NWC', 'WIO', 'NWC'),
        feature_group_count=x.shape[-1])
    return y + b.astype(x.dtype)


def rg_lru(x, w_rg, b_rg, w_ig, b_ig, lam):
    B, S, _ = x.shape
    xf = x.astype(jnp.float32)
    xb = xf.reshape(B, S, N_LRU_BLOCKS, LRU_BLOCK)
    r = jax.nn.sigmoid(jnp.einsum('bsnc,ncd->bsnd', xb, w_rg.astype(jnp.float32)).reshape(B, S, D_RNN) + b_rg.astype(jnp.float32))
    i = jax.nn.sigmoid(jnp.einsum('bsnc,ncd->bsnd', xb, w_ig.astype(jnp.float32)).reshape(B, S, D_RNN) + b_ig.astype(jnp.float32))
    log_a = -LRU_C * r * jax.nn.softplus(-lam.astype(jnp.float32))
    a = jnp.exp(log_a)
    mult = jnp.sqrt(-jnp.expm1(2.0 * log_a))
    mult = jnp.where(jnp.arange(S)[None, :, None] == 0, 1.0, mult)
    u = mult * (i * xf)

    def combine(left, right):
        a1, b1 = left
        a2, b2 = right
        return a1 * a2, a2 * b1 + b2

    _, h = lax.associative_scan(combine, (a, u), axis=1)
    return h.astype(x.dtype)


def partial_rope(t, cos, sin):
    half = ROPE_DIM // 2
    t1 = t[..., :half]
    t2 = t[..., half:ROPE_DIM]
    return jnp.concatenate([t1 * cos - t2 * sin, t2 * cos + t1 * sin, t[..., ROPE_DIM:]], axis=-1)


def dilated_window_attention(q, k, v, window, dilation):
    B, S, H, Dh = q.shape
    w_sub = window // dilation
    L = -(-S // dilation)
    nb = -(-L // Q_BLOCK)
    Lp = nb * Q_BLOCK
    pad = Lp * dilation - S

    def to_blocks(t):
        t = jnp.pad(t.astype(jnp.float32), ((0, 0), (0, pad), (0, 0), (0, 0)))
        t = t.reshape(B, Lp, dilation, H, Dh).transpose(0, 2, 1, 3, 4)
        return t.reshape(B, dilation, nb, Q_BLOCK, H, Dh)

    def with_prev(t):
        prev = jnp.pad(t[:, :, :-1], ((0, 0), (0, 0), (1, 0), (0, 0), (0, 0), (0, 0)))
        return jnp.concatenate([prev, t], axis=3)

    qb = to_blocks(q)
    kb = with_prev(to_blocks(k))
    vb = with_prev(to_blocks(v))

    qi = jnp.arange(Q_BLOCK)[:, None]
    kj = jnp.arange(2 * Q_BLOCK)[None, :]
    diff = qi + Q_BLOCK - kj
    band = (diff >= 0) & (diff <= w_sub)
    has_prev = (jnp.arange(nb)[:, None, None] > 0) | (kj[None] >= Q_BLOCK)
    mask = band[None] & has_prev

    s = jnp.einsum('brnqhc,brnkhc->brnhqk', qb, kb)
    s = jnp.where(mask[None, None, :, None], s, NEG)
    m = jnp.max(s, axis=-1, keepdims=True)
    p = jnp.exp(s - m)
    den = jnp.sum(p, axis=-1, keepdims=True)
    o = jnp.einsum('brnhqk,brnkhc->brnqhc', p, vb) / jnp.swapaxes(den, 3, 4)
    lse = jnp.swapaxes((m + jnp.log(den))[..., 0], 3, 4)

    o = o.reshape(B, dilation, Lp, H, Dh).transpose(0, 2, 1, 3, 4).reshape(B, Lp * dilation, H, Dh)[:, :S]
    lse = lse.reshape(B, dilation, Lp, H).transpose(0, 2, 1, 3).reshape(B, Lp * dilation, H)[:, :S]
    return o, lse


def setup_inputs(seed: int = 0) -> dict:
    key = jax.random.key(seed)
    ks = jax.random.split(key, 24)
    f32 = jnp.float32

    def nrm(k, shape, fan_in):
        return jax.random.normal(k, shape, f32) * (fan_in ** -0.5)

    def gain(k):
        return 1.0 + 0.02 * jax.random.normal(k, (DEPTH, D_MODEL), f32)

    x = jax.random.normal(ks[0], (BATCH, SEQ, D_MODEL), f32)
    offset = jax.random.randint(ks[1], (BATCH, 1), 0, 4096, dtype=jnp.int32)
    positions = offset + jnp.arange(SEQ, dtype=jnp.int32)[None, :]
    u = jax.random.uniform(ks[2], (DEPTH, D_RNN), f32, 0.9, 0.999)
    a_base = u ** (1.0 / LRU_C)
    lru_lambda = jnp.log(a_base) - jnp.log1p(-a_base)
    return {
        "x": x,
        "positions": positions,
        "pre_mix_norm": gain(ks[3]),
        "w_in": nrm(ks[4], (DEPTH, D_MODEL, IN_WIDTH), D_MODEL),
        "conv_w": nrm(ks[5], (DEPTH, CONV_WIDTH, D_RNN), CONV_WIDTH),
        "conv_b": 0.01 * jax.random.normal(ks[6], (DEPTH, D_RNN), f32),
        "w_rg": nrm(ks[7], (DEPTH, N_LRU_BLOCKS, LRU_BLOCK, LRU_BLOCK), LRU_BLOCK),
        "b_rg": 0.01 * jax.random.normal(ks[8], (DEPTH, D_RNN), f32),
        "w_ig": nrm(ks[9], (DEPTH, N_LRU_BLOCKS, LRU_BLOCK, LRU_BLOCK), LRU_BLOCK),
        "b_ig": 0.01 * jax.random.normal(ks[10], (DEPTH, D_RNN), f32),
        "lru_lambda": lru_lambda,
        "w_lru_proj": nrm(ks[11], (DEPTH, D_RNN, D_MODEL), D_RNN),
        "w_attn_proj": nrm(ks[12], (DEPTH, ATTN_OUT_WIDTH, D_MODEL), ATTN_OUT_WIDTH),
        "w_out": nrm(ks[13], (DEPTH, D_MODEL, D_MODEL), D_MODEL),
        "post_mix_norm": gain(ks[14]),
        "pre_ffn_norm": gain(ks[15]),
        "w_ffn_gate": nrm(ks[16], (DEPTH, D_MODEL, D_FF), D_MODEL),
        "w_ffn_up": nrm(ks[17], (DEPTH, D_MODEL, D_FF), D_MODEL),
        "w_ffn_down": nrm(ks[18], (DEPTH, D_FF, D_MODEL), D_FF),
        "post_ffn_norm": gain(ks[19]),
    }


def reference(x, positions, pre_mix_norm, w_in, conv_w, conv_b, w_rg, b_rg, w_ig, b_ig,
              lru_lambda, w_lru_proj, w_attn_proj, w_out, post_mix_norm, pre_ffn_norm,
              w_ffn_gate, w_ffn_up, w_ffn_down, post_ffn_norm):
    B, S, _ = x.shape
    dt = x.dtype
    inv_freq = ROPE_THETA ** (-jnp.arange(0, ROPE_DIM, 2, dtype=jnp.float32) / ROPE_DIM)
    ang = positions.astype(jnp.float32)[..., None] * inv_freq
    cos = jnp.cos(ang)[:, :, None, :].astype(dt)
    sin = jnp.sin(ang)[:, :, None, :].astype(dt)
    split_at = np.cumsum([D_RNN, D_RNN, ATTN_WIDTH, ATTN_WIDTH, ATTN_WIDTH]).tolist()

    for l in range(DEPTH):
        h = rms_norm(x, pre_mix_norm[l])
        proj = h @ w_in[l].astype(dt)
        xr, gr, q, k, v, gates = jnp.split(proj, split_at, axis=-1)

        xr = causal_depthwise_conv(xr, conv_w[l], conv_b[l])
        xr = rg_lru(xr, w_rg[l], b_rg[l], w_ig[l], b_ig[l], lru_lambda[l])
        y_lru = (xr * jax.nn.gelu(gr)) @ w_lru_proj[l].astype(dt)

        q = q.reshape(B, S, N_GROUPS, HEADS_PER_GROUP, HEAD_DIM)
        k = k.reshape(B, S, N_GROUPS, HEADS_PER_GROUP, HEAD_DIM)
        v = v.reshape(B, S, N_GROUPS, HEADS_PER_GROUP, HEAD_DIM)
        q = partial_rope(q, cos[:, :, None], sin[:, :, None]) * (HEAD_DIM ** -0.5)
        k = partial_rope(k, cos[:, :, None], sin[:, :, None])
        outs, lses = [], []
        for g, (window, dilation) in enumerate(ATTN_GROUPS):
            o_g, lse_g = dilated_window_attention(q[:, :, g], k[:, :, g], v[:, :, g], window, dilation)
            outs.append(o_g)
            lses.append(lse_g)
        o = jnp.stack(outs, axis=2)
        wts = jax.nn.softmax(jnp.stack(lses, axis=2), axis=2)
        o = jnp.sum(wts[..., None] * o, axis=2).reshape(B, S, ATTN_OUT_WIDTH).astype(dt)
        y_attn = o @ w_attn_proj[l].astype(dt)

        g_lru, g_attn = jnp.split(jax.nn.sigmoid(gates), N_BRANCHES, axis=-1)
        mix = (g_lru * y_lru + g_attn * y_attn) @ w_out[l].astype(dt)
        x = x + rms_norm(mix, post_mix_norm[l])

        h = rms_norm(x, pre_ffn_norm[l])
        f = (jax.nn.silu(h @ w_ffn_gate[l].astype(dt)) * (h @ w_ffn_up[l].astype(dt))) @ w_ffn_down[l].astype(dt)
        x = x + rms_norm(f, post_ffn_norm[l])
    return x
```

```cpp
#include <hip/hip_runtime.h>
#include <hip/hip_cooperative_groups.h>
#include <cstdio>
#include <cstdint>
namespace cg = cooperative_groups;
namespace pg8 {
#define PG8_LAS __attribute__((address_space(3)))
typedef unsigned short bf16_t;
typedef short bf16x8 __attribute__((ext_vector_type(8)));
typedef float f32x4 __attribute__((ext_vector_type(4)));
typedef unsigned u32x4 __attribute__((ext_vector_type(4)));
constexpr int BM = 256, BK = 64, HALF = 128, HTB = HALF * BK * 2  , STAGE_BYTES = 8 * HTB, NXCD = 8, WGM = 8;

__host__ __device__ __forceinline__ int lds_byte(int r, int c) { const int st = (r >> 4) * 2 + (c >> 5), rr = r & 15, cc = c & 31, ob = rr * 64 + cc * 2; return st * 1024 + (ob ^ (((ob >> 9) & 1) << 5)); }
__host__ __device__ __forceinline__ void stage_rc(int b, int& R, int& C) { const int st = b / 1024, sb = b % 1024, swz = sb ^ (((sb >> 9) & 1) << 5); R = (st >> 1) * 16 + swz / 64; C = (st & 1) * 32 + (swz % 64) / 2; }
__host__ __device__ __forceinline__ int perm32(int rho) { const int n = rho >> 4, i = rho & 15; return 8 * (i >> 2) + 4 * n + (i & 3); }

struct Unit { int pm, pn; };
struct Gemm { const bf16_t* A; const bf16_t* Bt; int M, N, K; };

struct StaticOrder {
    int nM, nN, nwg, G, c;
    __host__ __device__ void init(int M, int N, int G_, int c_) { nM = M / BM; nN = N / BM; nwg = nM * nN; G = G_; c = c_; }
    __host__ __device__ bool next(int i, Unit& u) const {
        const long L = (long)i * G + c; if (L >= nwg) return false;
        int wgid = (int)L; { const int q = nwg / NXCD, r = nwg % NXCD, xcd = wgid % NXCD, off = wgid / NXCD; wgid = (xcd < r ? xcd * (q + 1) : r * (q + 1) + (xcd - r) * q) + off; }
        const int nig = WGM * nN, gid = wgid / nig, fm = gid * WGM, gsz = (nM - fm) < WGM ? (nM - fm) : WGM;
        u.pm = fm + ((wgid % nig) % gsz); u.pn = (wgid % nig) / gsz; return true;
    }
    __device__ __forceinline__ void a_ready(const Unit&) const {}
    __device__ __forceinline__ void done(const Unit&) const {}
};
typedef __bf16 bf16x2_cv __attribute__((ext_vector_type(2)));
typedef float f32x2_cv __attribute__((ext_vector_type(2)));
__device__ __forceinline__ unsigned cvt_pk_bf16(float lo, float hi) { const f32x2_cv v = {lo, hi}; const bf16x2_cv b = __builtin_convertvector(v, bf16x2_cv); return __builtin_bit_cast(unsigned, b); }
typedef float f32x2 __attribute__((ext_vector_type(2)));
template <class Epi, class Sched, bool ALIGN_EPI = false, bool SP2 = false>
__device__ __forceinline__ void gemm_phase(PG8_LAS unsigned char* lds, const Gemm g, const Sched& S, const Epi& E) {
    const int tid = threadIdx.x, wid = __builtin_amdgcn_readfirstlane(tid >> 6), lane = tid & 63, wr = wid >> 2, wc = wid & 3, fr = lane & 15, fq = lane >> 4;
    const int K = g.K, nt = K / BK;
    unsigned voffA[2], voffB[2];
#pragma unroll
    for (int i = 0; i < 2; ++i) { int R, C; stage_rc(tid * 16 + i * 8192, R, C); const int Rb = Epi::PERM ? ((R & ~31) + perm32(R & 31)) : R;
        voffA[i] = (unsigned)(R * K + C) * 2u; voffB[i] = (unsigned)(Rb * K + C) * 2u; }
    const size_t kstep = (size_t)(BK * 2);
    const size_t hstep = (size_t)HALF * K * 2;
    const size_t tstep = 2 * hstep;
    const unsigned ldsw = (unsigned)wid * 1024u;
    const int aoff = lds_byte(wr * 64 + fr, fq * 8), boff = lds_byte(wc * 32 + fr, fq * 8);
#define PG8_SA(b, h) (((b) * 2 + (h)) * HTB)
#define PG8_SB(b, h) ((4 + (b) * 2 + (h)) * HTB)
#define PG8_STAGE(bufoff, gbase, voff) do { _Pragma("unroll") for (int _i = 0; _i < 2; ++_i) \
        __builtin_amdgcn_global_load_lds((const unsigned*)((const char*)(gbase) + (voff)[_i]), (PG8_LAS unsigned*)(lds + (bufoff) + ldsw + _i * 8192), 16, 0, 0); } while (0)
#define PG8_LDA(dst, b, h) do { _Pragma("unroll") for (int m = 0; m < 4; ++m) _Pragma("unroll") for (int k = 0; k < 2; ++k) dst[m][k] = *(const PG8_LAS bf16x8*)(lds + PG8_SA(b, h) + aoff + m * 2048 + k * 1024); } while (0)
#define PG8_LDB(dst, b, h) do { _Pragma("unroll") for (int n = 0; n < 2; ++n) _Pragma("unroll") for (int k = 0; k < 2; ++k) dst[n][k] = *(const PG8_LAS bf16x8*)(lds + PG8_SB(b, h) + boff + n * 2048 + k * 1024); } while (0)
#define PG8_MMA(ai, bj, At, Bt) do { __builtin_amdgcn_s_setprio(1); _Pragma("unroll") for (int m = 0; m < 4; ++m) _Pragma("unroll") for (int n = 0; n < 2; ++n) _Pragma("unroll") for (int k = 0; k < 2; ++k) \
        acc[ai][bj][m][n] = __builtin_amdgcn_mfma_f32_16x16x32_bf16(Bt[n][k], At[m][k], acc[ai][bj][m][n], 0, 0, 0); __builtin_amdgcn_s_setprio(0); } while (0)
#define PG8_WAIT_V(n) asm volatile("s_waitcnt vmcnt(" #n ")" ::: "memory")
#define PG8_WAIT_L(n) asm volatile("s_waitcnt lgkmcnt(" #n ")" ::: "memory")
#define PG8_BAR __builtin_amdgcn_s_barrier()
#define PG8_SCHED __builtin_amdgcn_sched_barrier(0)
    Unit cur, nxt; int ui = 0;
    if (!S.next(0, cur)) return;
    f32x4 acc[2][2][4][2];
#pragma unroll
    for (int a = 0; a < 2; ++a)
#pragma unroll
        for (int b = 0; b < 2; ++b)
#pragma unroll
            for (int m = 0; m < 4; ++m)
#pragma unroll
                for (int n = 0; n < 2; ++n) acc[a][b][m][n] = (f32x4){0.f, 0.f, 0.f, 0.f};
    bf16x8 At[4][2], B0[2][2], B1[2][2];
    const char* cA = (const char*)g.A + (size_t)cur.pm * tstep; const char* cB = (const char*)g.Bt + (size_t)cur.pn * tstep;
    S.a_ready(cur);
    if constexpr (SP2) {
        PG8_STAGE(PG8_SB(0, 0), cB, voffB); PG8_STAGE(PG8_SB(0, 1), cB + hstep, voffB); PG8_STAGE(PG8_SA(0, 0), cA, voffA); PG8_STAGE(PG8_SA(0, 1), cA + hstep, voffA);
        if (wr == 1) PG8_BAR;
        PG8_WAIT_V(2); PG8_BAR;
        PG8_STAGE(PG8_SB(1, 0), cB + kstep, voffB); PG8_STAGE(PG8_SA(1, 0), cA + kstep, voffA); PG8_STAGE(PG8_SB(1, 1), cB + hstep + kstep, voffB);
        PG8_WAIT_V(6); PG8_BAR;
    } else {
        PG8_STAGE(PG8_SB(0, 0), cB, voffB); PG8_STAGE(PG8_SA(0, 0), cA, voffA); PG8_STAGE(PG8_SB(0, 1), cB + hstep, voffB); PG8_STAGE(PG8_SA(0, 1), cA + hstep, voffA);
        if (wr == 1) PG8_BAR;
        PG8_WAIT_V(4); PG8_BAR;
        PG8_STAGE(PG8_SB(1, 0), cB + kstep, voffB); PG8_STAGE(PG8_SA(1, 0), cA + kstep, voffA); PG8_STAGE(PG8_SB(1, 1), cB + hstep + kstep, voffB);
        PG8_WAIT_V(6); PG8_BAR;
    }
    for (;;) {
        const bool has_next = S.next(ui + 1, nxt);
        const char* nA = has_next ? (const char*)g.A + (size_t)nxt.pm * tstep : cA; const char* nB = has_next ? (const char*)g.Bt + (size_t)nxt.pn * tstep : cB;
        for (int t = 0; t < nt; t += 2) {
            if constexpr (Epi::MIDK > 0) { if (t == Epi::MIDK) E.midk(acc, cur, wr, wc, fr, fq); }
            const bool last = (t == nt - 2);
            const char* a1 = cA + (size_t)(t + 1) * kstep;
            const char* a2 = last ? nA : cA + (size_t)(t + 2) * kstep; const char* b2 = last ? nB : cB + (size_t)(t + 2) * kstep;
            const char* a3 = a2 + kstep; const char* b3 = b2 + kstep;
            if (last && has_next) S.a_ready(nxt);
            if constexpr (SP2) {
            PG8_LDB(B0, 0, 0); PG8_LDB(B1, 0, 1); PG8_SCHED; PG8_LDA(At, 0, 0); PG8_STAGE(PG8_SA(1, 1), a1 + hstep, voffA);
            PG8_WAIT_V(8); PG8_WAIT_L(0); PG8_BAR; PG8_MMA(0, 0, At, B0); PG8_MMA(0, 1, At, B1); PG8_BAR; PG8_SCHED;
            PG8_LDA(At, 0, 1); PG8_STAGE(PG8_SB(0, 0), b2, voffB); PG8_STAGE(PG8_SB(0, 1), b2 + hstep, voffB); PG8_STAGE(PG8_SA(0, 0), a2, voffA);
            PG8_WAIT_V(8); PG8_WAIT_L(0); PG8_BAR; PG8_MMA(1, 0, At, B0); PG8_MMA(1, 1, At, B1); PG8_BAR; PG8_SCHED;
            PG8_LDB(B0, 1, 0); PG8_LDB(B1, 1, 1); PG8_SCHED; PG8_LDA(At, 1, 0); PG8_STAGE(PG8_SA(0, 1), a2 + hstep, voffA);
            PG8_WAIT_V(8); PG8_WAIT_L(0); PG8_BAR; PG8_MMA(0, 0, At, B0); PG8_MMA(0, 1, At, B1); PG8_BAR; PG8_SCHED;
            PG8_LDA(At, 1, 1); PG8_STAGE(PG8_SB(1, 0), b3, voffB); PG8_STAGE(PG8_SB(1, 1), b3 + hstep, voffB); PG8_STAGE(PG8_SA(1, 0), a3, voffA);
            PG8_WAIT_V(8); PG8_WAIT_L(0); PG8_BAR; PG8_MMA(1, 0, At, B0); PG8_MMA(1, 1, At, B1); PG8_BAR; PG8_SCHED;
            } else {
            PG8_LDB(B0, 0, 0); PG8_SCHED; PG8_LDA(At, 0, 0); PG8_STAGE(PG8_SA(1, 1), a1 + hstep, voffA);
            PG8_WAIT_L(8); PG8_BAR; PG8_WAIT_L(0); PG8_MMA(0, 0, At, B0); PG8_BAR; PG8_SCHED;
            PG8_LDB(B1, 0, 1); PG8_STAGE(PG8_SB(0, 0), b2, voffB);
            PG8_BAR; PG8_WAIT_L(0); PG8_MMA(0, 1, At, B1); PG8_BAR;
            PG8_LDA(At, 0, 1); PG8_STAGE(PG8_SA(0, 0), a2, voffA);
            PG8_BAR; PG8_WAIT_L(0); PG8_MMA(1, 0, At, B0); PG8_BAR; PG8_SCHED;
            PG8_STAGE(PG8_SB(0, 1), b2 + hstep, voffB);
            PG8_WAIT_V(6); PG8_BAR; PG8_MMA(1, 1, At, B1); PG8_BAR;
            PG8_LDB(B0, 1, 0); PG8_SCHED; PG8_LDA(At, 1, 0); PG8_STAGE(PG8_SA(0, 1), a2 + hstep, voffA);
            PG8_WAIT_L(8); PG8_BAR; PG8_WAIT_L(0); PG8_MMA(0, 0, At, B0); PG8_BAR; PG8_SCHED;
            PG8_LDB(B1, 1, 1); PG8_STAGE(PG8_SB(1, 0), b3, voffB);
            PG8_BAR; PG8_WAIT_L(0); PG8_MMA(0, 1, At, B1); PG8_BAR;
            PG8_LDA(At, 1, 1); PG8_STAGE(PG8_SA(1, 0), a3, voffA);
            PG8_BAR; PG8_WAIT_L(0); PG8_MMA(1, 0, At, B0); PG8_BAR; PG8_SCHED;
            PG8_STAGE(PG8_SB(1, 1), b3 + hstep, voffB);
            PG8_WAIT_V(6); PG8_BAR; PG8_MMA(1, 1, At, B1); PG8_BAR;
            }
        }
        if constexpr (ALIGN_EPI) { if (wr == 0) PG8_BAR; }
        if constexpr (!Epi::AFTER_DRAIN) { E(acc, cur, wr, wc, fr, fq); S.done(cur); }
        if (!has_next) break;
#pragma unroll
        for (int a = 0; a < 2; ++a)
#pragma unroll
            for (int b = 0; b < 2; ++b)
#pragma unroll
                for (int m = 0; m < 4; ++m)
#pragma unroll
                    for (int n = 0; n < 2; ++n) acc[a][b][m][n] = (f32x4){0.f, 0.f, 0.f, 0.f};
        cur = nxt; cA = nA; cB = nB; ++ui;
        if constexpr (ALIGN_EPI) { if (wr == 1) PG8_BAR; }
    }
    PG8_WAIT_V(0);
    if constexpr (!ALIGN_EPI) { if (wr == 0) PG8_BAR; }
    PG8_BAR;
    if constexpr (Epi::AFTER_DRAIN) { E.fused(acc, cur, wr, wc, fr, fq, lds, wid, lane); S.done(cur); }
#undef PG8_SA
#undef PG8_SB
#undef PG8_STAGE
#undef PG8_LDA
#undef PG8_LDB
#undef PG8_MMA
#undef PG8_WAIT_V
#undef PG8_WAIT_L
#undef PG8_BAR
#undef PG8_SCHED
}
}

#ifndef PG8_SP2
#define PG8_SP2 true
#endif
#ifndef PG8_ALIGN
#define PG8_ALIGN true
#endif
#ifndef MK_MULTI
#define MK_MULTI 0
#endif

constexpr int D = 1024, BATCH = 32, SEQ = 2048, M = BATCH * SEQ;
constexpr int AW = 1536, INW = 8704, NA = 6656, NGATE = 2048, DFF = 2816;
constexpr float EPS = 1e-6f;
constexpr int NPHASE = 11;

constexpr size_t MiB = 1u << 20;
constexpr size_t WS_WIN = 1 * MiB, WS_WLA = 18 * MiB, WS_WOUT = 21 * MiB, WS_WGU = 23 * MiB, WS_WD = 34 * MiB;
constexpr size_t WS_RSQ1 = 39 * MiB + 512 * 1024, WS_RSQ2 = 39 * MiB + 768 * 1024;
constexpr size_t WS_XR = 40 * MiB, WS_GR = 168 * MiB, WS_Q = 296 * MiB, WS_K = 488 * MiB, WS_V = 680 * MiB, WS_H = 872 * MiB;
constexpr size_t WS_ROPE = 1000 * MiB, WS_LSE = 1008 * MiB, WS_WGT = 1012 * MiB, WS_END = 1016 * MiB;
constexpr size_t WS_GATES = WS_XR, WS_MIXIN = WS_K, WS_MIX = WS_GR, WS_H2 = WS_H, WS_ACT = WS_K, WS_F = WS_XR;

constexpr int LDS_BYTES = 147456;

#define GAS __attribute__((address_space(1)))
#define LAS __attribute__((address_space(3)))
typedef unsigned short bf16;
typedef unsigned u32x4 __attribute__((ext_vector_type(4)));
typedef unsigned u32x2 __attribute__((ext_vector_type(2)));
typedef float f32x4 __attribute__((ext_vector_type(4)));
typedef short bf16x8 __attribute__((ext_vector_type(8)));
typedef short s16x4 __attribute__((ext_vector_type(4)));
#define LDS_WAIT() asm volatile("s_waitcnt lgkmcnt(0)" ::: "memory")

__device__ __forceinline__ float bflo(unsigned u) { return __uint_as_float(u << 16); }
__device__ __forceinline__ float bfhi(unsigned u) { return __uint_as_float(u & 0xffff0000u); }
__device__ __forceinline__ unsigned pk2(float lo, float hi) { return pg8::cvt_pk_bf16(lo, hi); }
__device__ __forceinline__ float frcp(float x) { return __builtin_amdgcn_rcpf(x); }
__device__ __forceinline__ float fsigmoid(float x) { return frcp(1.f + __expf(-x)); }
__device__ __forceinline__ float fgelu_tanh(float x) { const float z = 0.7978845608028654f * (x + 0.044715f * x * x * x); return x * frcp(1.f + __expf(-2.f * z)); }
__device__ __forceinline__ float wave_sum(float v) {
#pragma unroll
    for (int o = 1; o < 64; o <<= 1) v += __shfl_xor(v, o);
    return v;
}

using pg8::Unit;
struct EpiProj {
    static constexpr bool PERM = true, AFTER_DRAIN = false; static constexpr int MIDK = 0;
    bf16 *XR, *GR, *Q, *K, *V; const float* cs;
    __device__ __forceinline__ void operator()(const f32x4 (&acc)[2][2][4][2], const Unit& u, int wr, int wc, int fr, int fq) const {
        asm volatile("" : "+v"(fr), "+v"(fq));
        const int pn = u.pn; bf16* dst; int ldc, colt, mode;
        if (pn < 4) { dst = XR; ldc = 1024; colt = pn * 256; mode = 0; }
        else if (pn < 8) { dst = GR; ldc = 1024; colt = (pn - 4) * 256; mode = 1; }
        else if (pn < 14) { dst = Q; ldc = 1536; colt = (pn - 8) * 256; mode = 2; }
        else if (pn < 20) { dst = K; ldc = 1536; colt = (pn - 14) * 256; mode = 3; }
        else { dst = V; ldc = 1536; colt = (pn - 20) * 256; mode = 0; }
        const int row0 = u.pm * 256 + wr * 64 + fr, col0 = colt + wc * 32 + 8 * fq;
        const float qs = (mode == 2) ? 0.08838834764831845f : 1.f;
        const bool rope = (mode >= 2) && (wc == 0);
        const float sgn = (fq < 2) ? -1.f : 1.f;
#pragma unroll
        for (int ai = 0; ai < 2; ++ai)
#pragma unroll
            for (int m = 0; m < 4; ++m) {
                const int row = row0 + ai * 128 + m * 16; bf16* rowp = dst + (size_t)row * ldc + col0;
                f32x4 c0 = {1.f, 1.f, 1.f, 1.f}, c1 = c0, s0 = {0.f, 0.f, 0.f, 0.f}, s1 = s0;
                if (rope) { const float* cp = cs + (size_t)row * 32 + 8 * (fq & 1); c0 = *(const f32x4*)cp; c1 = *(const f32x4*)(cp + 4); s0 = *(const f32x4*)(cp + 16); s1 = *(const f32x4*)(cp + 20); s0 = s0 * sgn; s1 = s1 * sgn; }
#pragma unroll
                for (int bj = 0; bj < 2; ++bj) {
                    f32x4 v0 = acc[ai][bj][m][0], v1 = acc[ai][bj][m][1];
                    if (mode == 1) {
#pragma unroll
                        for (int j = 0; j < 4; ++j) { v0[j] = fgelu_tanh(v0[j]); v1[j] = fgelu_tanh(v1[j]); }
                    }
                    if (rope) {
                        f32x4 p0, p1;
#pragma unroll
                        for (int j = 0; j < 4; ++j) { p0[j] = __shfl_xor(v0[j], 32); p1[j] = __shfl_xor(v1[j], 32); }
                        v0 = v0 * c0 + p0 * s0; v1 = v1 * c1 + p1 * s1;
                    }
                    v0 = v0 * qs; v1 = v1 * qs;
                    u32x4 w; w.x = pk2(v0[0], v0[1]); w.y = pk2(v0[2], v0[3]); w.z = pk2(v1[0], v1[1]); w.w = pk2(v1[2], v1[3]);
                    *(u32x4*)(rowp + bj * 128) = w;
                }
            }
    }
};
struct EpiSigmoid {
    static constexpr bool PERM = true, AFTER_DRAIN = false; static constexpr int MIDK = 0;
    bf16* O; int ldc;
    __device__ __forceinline__ void operator()(const f32x4 (&acc)[2][2][4][2], const Unit& u, int wr, int wc, int fr, int fq) const {
        asm volatile("" : "+v"(fr), "+v"(fq));
        const int row0 = u.pm * 256 + wr * 64 + fr, col0 = u.pn * 256 + wc * 32 + 8 * fq;
#pragma unroll
        for (int ai = 0; ai < 2; ++ai)
#pragma unroll
            for (int m = 0; m < 4; ++m) { bf16* rowp = O + (size_t)(row0 + ai * 128 + m * 16) * ldc + col0;
#pragma unroll
                for (int bj = 0; bj < 2; ++bj) { f32x4 v0 = acc[ai][bj][m][0], v1 = acc[ai][bj][m][1];
#pragma unroll
                    for (int j = 0; j < 4; ++j) { v0[j] = fsigmoid(v0[j]); v1[j] = fsigmoid(v1[j]); }
                    u32x4 w; w.x = pk2(v0[0], v0[1]); w.y = pk2(v0[2], v0[3]); w.z = pk2(v1[0], v1[1]); w.w = pk2(v1[2], v1[3]);
                    *(u32x4*)(rowp + bj * 128) = w; } }
    }
};
struct EpiMerge {
    static constexpr bool PERM = true, AFTER_DRAIN = false; static constexpr int MIDK = 16;
    const bf16* G; bf16* O;
    __device__ __forceinline__ void midk(f32x4 (&acc)[2][2][4][2], const Unit& u, int wr, int wc, int fr, int fq) const {
        asm volatile("" : "+v"(fr), "+v"(fq));
        const int row0 = u.pm * 256 + wr * 64 + fr, col0 = u.pn * 256 + wc * 32 + 8 * fq;
#pragma unroll
        for (int ai = 0; ai < 2; ++ai)
#pragma unroll
            for (int m = 0; m < 4; ++m) { const bf16* gp = G + (size_t)(row0 + ai * 128 + m * 16) * 2048 + col0;
#pragma unroll
                for (int bj = 0; bj < 2; ++bj) { const u32x4 gl = *(const u32x4*)(gp + bj * 128), ga = *(const u32x4*)(gp + 1024 + bj * 128);
                    f32x4 r0, r1;
                    r0[0] = bflo(gl.x) * frcp(bflo(ga.x)); r0[1] = bfhi(gl.x) * frcp(bfhi(ga.x)); r0[2] = bflo(gl.y) * frcp(bflo(ga.y)); r0[3] = bfhi(gl.y) * frcp(bfhi(ga.y));
                    r1[0] = bflo(gl.z) * frcp(bflo(ga.z)); r1[1] = bfhi(gl.z) * frcp(bfhi(ga.z)); r1[2] = bflo(gl.w) * frcp(bflo(ga.w)); r1[3] = bfhi(gl.w) * frcp(bfhi(ga.w));
                    acc[ai][bj][m][0] = acc[ai][bj][m][0] * r0; acc[ai][bj][m][1] = acc[ai][bj][m][1] * r1;
                    asm volatile("" : "+v"(acc[ai][bj][m][0]), "+v"(acc[ai][bj][m][1]) :: "memory"); } }
    }
    __device__ __forceinline__ void operator()(const f32x4 (&acc)[2][2][4][2], const Unit& u, int wr, int wc, int fr, int fq) const {
        asm volatile("" : "+v"(fr), "+v"(fq));
        const int row0 = u.pm * 256 + wr * 64 + fr, col0 = u.pn * 256 + wc * 32 + 8 * fq;
#pragma unroll
        for (int ai = 0; ai < 2; ++ai)
#pragma unroll
            for (int m = 0; m < 4; ++m) { const size_t row = (size_t)(row0 + ai * 128 + m * 16); const bf16* gp = G + row * 2048 + 1024 + col0; bf16* op = O + row * 1024 + col0;
#pragma unroll
                for (int bj = 0; bj < 2; ++bj) { const u32x4 ga = *(const u32x4*)(gp + bj * 128);
                    f32x4 v0 = acc[ai][bj][m][0], v1 = acc[ai][bj][m][1];
                    v0[0] *= bflo(ga.x); v0[1] *= bfhi(ga.x); v0[2] *= bflo(ga.y); v0[3] *= bfhi(ga.y); v1[0] *= bflo(ga.z); v1[1] *= bfhi(ga.z); v1[2] *= bflo(ga.w); v1[3] *= bfhi(ga.w);
                    u32x4 w; w.x = pk2(v0[0], v0[1]); w.y = pk2(v0[2], v0[3]); w.z = pk2(v1[0], v1[1]); w.w = pk2(v1[2], v1[3]);
                    *(u32x4*)(op + bj * 128) = w; }
                asm volatile("" ::: "memory"); }
    }
};
struct EpiSq {
    static constexpr bool PERM = true, AFTER_DRAIN = false; static constexpr int MIDK = 0;
    bf16* O; float* rowsq;
    __device__ __forceinline__ void operator()(const f32x4 (&acc)[2][2][4][2], const Unit& u, int wr, int wc, int fr, int fq) const {
        asm volatile("" : "+v"(fr), "+v"(fq));
        const int row0 = u.pm * 256 + wr * 64 + fr, col0 = u.pn * 256 + wc * 32 + 8 * fq;
#pragma unroll
        for (int ai = 0; ai < 2; ++ai)
#pragma unroll
            for (int m = 0; m < 4; ++m) { const int row = row0 + ai * 128 + m * 16; bf16* op = O + (size_t)row * 1024 + col0; float s = 0.f;
#pragma unroll
                for (int bj = 0; bj < 2; ++bj) { const f32x4 v0 = acc[ai][bj][m][0], v1 = acc[ai][bj][m][1];
                    s += (v0[0] * v0[0] + v0[1] * v0[1]) + (v0[2] * v0[2] + v0[3] * v0[3]) + (v1[0] * v1[0] + v1[1] * v1[1]) + (v1[2] * v1[2] + v1[3] * v1[3]);
                    u32x4 w; w.x = pk2(v0[0], v0[1]); w.y = pk2(v0[2], v0[3]); w.z = pk2(v1[0], v1[1]); w.w = pk2(v1[2], v1[3]);
                    *(u32x4*)(op + bj * 128) = w; }
                s += __shfl_xor(s, 16); s += __shfl_xor(s, 32);
                if (fq == 0) __hip_atomic_fetch_add(rowsq + row, s, __ATOMIC_RELAXED, __HIP_MEMORY_SCOPE_AGENT); }
    }
};
struct EpiSwiglu {
    static constexpr bool PERM = true, AFTER_DRAIN = false; static constexpr int MIDK = 0;
    bf16* O;
    __device__ __forceinline__ void operator()(const f32x4 (&acc)[2][2][4][2], const Unit& u, int wr, int wc, int fr, int fq) const {
        asm volatile("" : "+v"(fr), "+v"(fq));
        const int row0 = u.pm * 256 + wr * 64 + fr, col0 = u.pn * 128 + wc * 32 + 8 * fq;
#pragma unroll
        for (int ai = 0; ai < 2; ++ai)
#pragma unroll
            for (int m = 0; m < 4; ++m) { bf16* op = O + (size_t)(row0 + ai * 128 + m * 16) * DFF + col0;
                f32x4 v0 = acc[ai][0][m][0], v1 = acc[ai][0][m][1]; const f32x4 u0 = acc[ai][1][m][0], u1 = acc[ai][1][m][1];
#pragma unroll
                for (int j = 0; j < 4; ++j) { v0[j] = v0[j] * fsigmoid(v0[j]) * u0[j]; v1[j] = v1[j] * fsigmoid(v1[j]) * u1[j]; }
                u32x4 w; w.x = pk2(v0[0], v0[1]); w.y = pk2(v0[2], v0[3]); w.z = pk2(v1[0], v1[1]); w.w = pk2(v1[2], v1[3]);
                *(u32x4*)op = w; }
    }
};

struct Args { const float* in[20]; float* out; unsigned char* ws; float invf[16]; int ph_lo, ph_hi; };
static_assert(sizeof(Args) == 20 * 8 + 8 + 8 + 64 + 8, "Args has no padding");

__device__ __forceinline__ void p0_transpose_item(const float* W, int ldw, bf16* WT, int ldt, int k0, int n0, int drow0, int dcol0, LAS float* scr, int lane) {
#pragma unroll 8
    for (int i = 0; i < 32; ++i) { const int kk = 2 * i + (lane >> 5); scr[kk * 33 + (lane & 31)] = W[(size_t)(k0 + kk) * ldw + n0 + (lane & 31)]; }
    LDS_WAIT(); asm volatile("" ::: "memory");
    const int c = lane & 7;
#pragma unroll
    for (int j = 0; j < 4; ++j) { const int n = (lane >> 3) + 8 * j; const LAS float* s = scr + (8 * c) * 33 + n;
        u32x4 o; o.x = pk2(s[0 * 33], s[1 * 33]); o.y = pk2(s[2 * 33], s[3 * 33]); o.z = pk2(s[4 * 33], s[5 * 33]); o.w = pk2(s[6 * 33], s[7 * 33]);
        *(u32x4*)(WT + (size_t)(drow0 + n) * ldt + dcol0 + 8 * c) = o; }
    LDS_WAIT(); asm volatile("" ::: "memory");
}
__device__ __forceinline__ void p0_prologue(const Args& a, LAS unsigned char* lds, int tid, int lane, int wave) {
    unsigned char* ws = a.ws;
    LAS float* scr = (LAS float*)(lds + wave * 16384);
    const int gw = blockIdx.x * 8 + wave, NGW = gridDim.x * 8;
    constexpr int I0 = 16 * 272, I1 = 16 * 32, I2 = 8 * 32, I3 = 16 * 32, I4 = 16 * 88, I5 = 16 * 88, I6 = 44 * 32;
    constexpr int NITEMS = I0 + I1 + I2 + I3 + I4 + I5 + I6;
    for (int it = gw; it < NITEMS; it += NGW) {
        int r = it;
        if (r < I0) { const int kb = r / 272, nb = r % 272; if (nb < 208) p0_transpose_item(a.in[3], INW, (bf16*)(ws + WS_WIN), 1024, kb * 64, nb * 32, nb * 32, kb * 64, scr, lane); else p0_transpose_item(a.in[3], INW, (bf16*)(ws + WS_WGT), 1024, kb * 64, nb * 32, nb * 32 - NA, kb * 64, scr, lane); continue; } r -= I0;
        if (r < I1) { const int kb = r / 32, nb = r % 32; p0_transpose_item(a.in[11], 1024, (bf16*)(ws + WS_WLA), 1536, kb * 64, nb * 32, nb * 32, kb * 64, scr, lane); continue; } r -= I1;
        if (r < I2) { const int kb = r / 32, nb = r % 32; p0_transpose_item(a.in[12], 1024, (bf16*)(ws + WS_WLA), 1536, kb * 64, nb * 32, nb * 32, 1024 + kb * 64, scr, lane); continue; } r -= I2;
        if (r < I3) { const int kb = r / 32, nb = r % 32; p0_transpose_item(a.in[13], 1024, (bf16*)(ws + WS_WOUT), 1024, kb * 64, nb * 32, nb * 32, kb * 64, scr, lane); continue; } r -= I3;
        if (r < I4) { const int kb = r / 88, nb = r % 88, n0 = nb * 32; p0_transpose_item(a.in[16], DFF, (bf16*)(ws + WS_WGU), 1024, kb * 64, n0, 256 * (n0 >> 7) + (n0 & 127), kb * 64, scr, lane); continue; } r -= I4;
        if (r < I5) { const int kb = r / 88, nb = r % 88, n0 = nb * 32; p0_transpose_item(a.in[17], DFF, (bf16*)(ws + WS_WGU), 1024, kb * 64, n0, 256 * (n0 >> 7) + 128 + (n0 & 127), kb * 64, scr, lane); continue; } r -= I5;
        { const int kb = r / 32, nb = r % 32; p0_transpose_item(a.in[18], 1024, (bf16*)(ws + WS_WD), DFF, kb * 64, nb * 32, nb * 32, kb * 64, scr, lane); }
    }
    { const float* g = a.in[2]; bf16* H = (bf16*)(ws + WS_H);
      f32x4 gv[4];
#pragma unroll
      for (int j = 0; j < 4; ++j) gv[j] = *((const f32x4*)g + lane + 64 * j);
      for (int m = gw; m < M; m += NGW) {
        const f32x4* xr = (const f32x4*)(a.in[0] + (size_t)m * D) + lane; f32x4 v[4]; float s = 0.f;
#pragma unroll
        for (int j = 0; j < 4; ++j) { v[j] = xr[64 * j]; s += (v[j].x * v[j].x + v[j].y * v[j].y) + (v[j].z * v[j].z + v[j].w * v[j].w); }
        const float rstd = rsqrtf(wave_sum(s) * (1.f / D) + EPS);
        u32x2* o8 = (u32x2*)(H + (size_t)m * D) + lane;
#pragma unroll
        for (int j = 0; j < 4; ++j) { const f32x4 t = v[j] * rstd * gv[j]; u32x2 w; w.x = pk2(t.x, t.y); w.y = pk2(t.z, t.w); o8[64 * j] = w; }
      } }
    { const int* pos = (const int*)a.in[1]; float* cs = (float*)(ws + WS_ROPE); float* rsq = (float*)(ws + WS_RSQ1);
      const int gt = blockIdx.x * 512 + tid, NT = gridDim.x * 512;
      for (int i = gt; i < M * 16; i += NT) { const int m = i >> 4, f = i & 15;
          const float ang = (float)pos[m] * a.invf[f];
          const double ad = (double)ang; const double k = __builtin_rint(ad * 0.15915494309189535); const float rr = (float)(ad - k * 6.283185307179586);
          cs[m * 32 + f] = cosf(rr); cs[m * 32 + 16 + f] = sinf(rr); }
      for (int i = gt; i < 2 * M; i += NT) rsq[i] = 0.f; }
}

__device__ __forceinline__ unsigned offb(unsigned row, unsigned ch) { return 256u * row + 16u * (ch ^ (((row & 3u) << 2) | ((row >> 2) & 3u))); }
__device__ __forceinline__ void attn_unit(LAS unsigned char* lds, bf16* QO, const bf16* Kg, const bf16* Vg, float* LSE, int unit, int tid, int wave, int lane) {
    const int b = unit / 192, rem = unit - b * 192, gh = rem >> 4, rn = rem & 15, g = gh >> 2, hh = gh & 3;
    const int dsh = 2 * g, nbsh = 4 - dsh, r = rn >> nbsh, n = rn & ((1 << nbsh) - 1);
    const int colbase = g * 512 + hh * 128; const size_t rowb = (size_t)b * SEQ;
    {
        const int ch = tid & 15, r0 = tid >> 4; u32x4 kv[8], vv[8];
#pragma unroll
        for (int i = 0; i < 8; ++i) { const int row = r0 + 32 * i, blk = n - 1 + (i >> 2);
            if (blk >= 0) { const int tok = ((blk * 128 + (row & 127)) << dsh) + r; const size_t off = (rowb + tok) * AW + colbase + ch * 8; kv[i] = *(const u32x4*)(Kg + off); vv[i] = *(const u32x4*)(Vg + off); }
            else { kv[i] = (u32x4){0u, 0u, 0u, 0u}; vv[i] = kv[i]; } }
#pragma unroll
        for (int i = 0; i < 8; ++i) { const unsigned o = offb(r0 + 32 * i, ch); *(LAS u32x4*)(lds + o) = kv[i]; *(LAS u32x4*)(lds + 65536 + o) = vv[i]; }
    }
    const int li = lane & 15, g4 = lane >> 4, qi = 16 * wave + li;
    const int tq = ((n * 128 + qi) << dsh) + r;
    bf16* qrow = QO + (rowb + tq) * AW + colbase;
    bf16x8 qf[4];
#pragma unroll
    for (int dc = 0; dc < 4; ++dc) qf[dc] = *(const bf16x8*)(qrow + dc * 32 + 8 * g4);
    __syncthreads();
    const int kap = (li & 3) + 8 * ((li >> 2) & 1) + 4 * (li >> 3);
    const int kg = 8 * (g4 & 1) + 4 * (g4 >> 1);
    float s[9][4];
#pragma unroll
    for (int cc = 0; cc < 9; ++cc) { const int c = wave + cc; f32x4 acc = {0.f, 0.f, 0.f, 0.f};
#pragma unroll
        for (int dc = 0; dc < 4; ++dc) { const bf16x8 ka = *(const LAS bf16x8*)(lds + offb(c * 16 + kap, dc * 4 + g4)); acc = __builtin_amdgcn_mfma_f32_16x16x32_bf16(ka, qf[dc], acc, 0, 0, 0); }
#pragma unroll
        for (int jj = 0; jj < 4; ++jj) { const int j = c * 16 + kg + jj; const bool ok = (j >= qi) && (j <= qi + 128) && (n > 0 || j >= 128); s[cc][jj] = ok ? acc[jj] : -1e30f; } }
    float mx = -1e30f;
#pragma unroll
    for (int cc = 0; cc < 9; ++cc)
#pragma unroll
        for (int jj = 0; jj < 4; ++jj) mx = fmaxf(mx, s[cc][jj]);
    mx = fmaxf(mx, __shfl_xor(mx, 16)); mx = fmaxf(mx, __shfl_xor(mx, 32));
    float den = 0.f;
#pragma unroll
    for (int cc = 0; cc < 9; ++cc)
#pragma unroll
        for (int jj = 0; jj < 4; ++jj) { const float p = __expf(s[cc][jj] - mx); s[cc][jj] = p; den += p; }
    den += __shfl_xor(den, 16); den += __shfl_xor(den, 32);
    f32x4 o[8];
#pragma unroll
    for (int d = 0; d < 8; ++d) o[d] = (f32x4){0.f, 0.f, 0.f, 0.f};
    const unsigned q4 = (unsigned)li >> 2, p4 = (unsigned)li & 3u, rg = (unsigned)kg + q4;
#pragma unroll
    for (int pp = 0; pp < 5; ++pp) {
        const int c0 = wave + 2 * pp, c1 = (c0 + 1 > 15) ? 15 : c0 + 1;
        union { bf16x8 v; unsigned u[4]; } pf;
        pf.u[0] = pk2(s[2 * pp][0], s[2 * pp][1]); pf.u[1] = pk2(s[2 * pp][2], s[2 * pp][3]);
        if (pp < 4) { pf.u[2] = pk2(s[2 * pp + 1][0], s[2 * pp + 1][1]); pf.u[3] = pk2(s[2 * pp + 1][2], s[2 * pp + 1][3]); } else { pf.u[2] = 0u; pf.u[3] = 0u; }
        s16x4 lo[8], hi[8];
#pragma unroll
        for (int d = 0; d < 8; ++d) {
            const unsigned a0 = 65536u + offb((unsigned)c0 * 16u + rg, 2u * d + (p4 >> 1)) + 8u * (p4 & 1u), a1 = 65536u + offb((unsigned)c1 * 16u + rg, 2u * d + (p4 >> 1)) + 8u * (p4 & 1u);
            asm volatile("ds_read_b64_tr_b16 %0, %1" : "=&v"(lo[d]) : "v"((LAS unsigned char*)lds + a0) : "memory");
            asm volatile("ds_read_b64_tr_b16 %0, %1" : "=&v"(hi[d]) : "v"((LAS unsigned char*)lds + a1) : "memory");
        }
        asm volatile("s_waitcnt lgkmcnt(0)" ::: "memory"); __builtin_amdgcn_sched_barrier(0);
#pragma unroll
        for (int d = 0; d < 8; ++d) { const bf16x8 vf = (bf16x8){lo[d][0], lo[d][1], lo[d][2], lo[d][3], hi[d][0], hi[d][1], hi[d][2], hi[d][3]};
            o[d] = __builtin_amdgcn_mfma_f32_16x16x32_bf16(vf, pf.v, o[d], 0, 0, 0); }
    }
    const float inv = frcp(den);
#pragma unroll
    for (int d = 0; d < 8; ++d) { u32x2 w; w.x = pk2(o[d][0] * inv, o[d][1] * inv); w.y = pk2(o[d][2] * inv, o[d][3] * inv); *(u32x2*)(qrow + d * 16 + 4 * g4) = w; }
    if (g4 == 0) LSE[(rowb + tq) * 12 + gh] = mx + __logf(den);
    __syncthreads();
}

constexpr int LRU_T = 128, LRU_US = 68;
constexpr int LRU_U = 0, LRU_A = LRU_T * LRU_US * 4, LRU_XB = 2 * LRU_T * LRU_US * 4, LRU_SEG = LRU_XB + LRU_T * 128, LRU_CARRY = LRU_SEG + 8 * 64 * 8;
static_assert(LRU_CARRY + 256 <= 131072, "LRU LDS map");
__device__ __forceinline__ void lru_unit(LAS unsigned char* lds, const Args& a, int unit, int tid, int wave, int lane) {
    unsigned char* ws = a.ws;
    const int b = unit >> 4, nb = unit & 15; const size_t rowb = (size_t)b * SEQ;
    const bf16* XR = (const bf16*)(ws + WS_XR) + rowb * 1024 + nb * 64;
    const bf16* GR = (const bf16*)(ws + WS_GR) + rowb * 1024 + nb * 64;
    bf16* YO = (bf16*)a.out + rowb * 1536 + nb * 64;
    LAS float* U = (LAS float*)(lds + LRU_U); LAS float* Aim = (LAS float*)(lds + LRU_A); LAS float* SEG = (LAS float*)(lds + LRU_SEG); LAS float* CAR = (LAS float*)(lds + LRU_CARRY);
    const int li = lane & 15, g4 = lane >> 4;
    bf16x8 wf[8][2];
    { const float* wr_ = a.in[6] + (size_t)nb * 4096; const float* wi_ = a.in[8] + (size_t)nb * 4096;
#pragma unroll
      for (int nc = 0; nc < 8; ++nc)
#pragma unroll
        for (int kc = 0; kc < 2; ++kc) { const float* wsrc = (nc < 4 ? wr_ : wi_) + (size_t)(kc * 32 + 8 * g4) * 64 + (nc & 3) * 16 + li;
            union { bf16x8 v; unsigned u[4]; } t;
#pragma unroll
            for (int e = 0; e < 4; ++e) t.u[e] = pk2(wsrc[(2 * e) * 64], wsrc[(2 * e + 1) * 64]);
            wf[nc][kc] = t.v; } }
    float br[4], bi[4], sp[4];
#pragma unroll
    for (int nc = 0; nc < 4; ++nc) { const int ch = nb * 64 + nc * 16 + li; br[nc] = a.in[7][ch]; bi[nc] = a.in[9][ch];
        const float lam = a.in[10][ch]; sp[nc] = 8.f * (fmaxf(-lam, 0.f) + log1pf(__expf(-fabsf(lam)))); }
    const int cg = tid & 7, ct = tid >> 3;
    float cw[4][8], cb[8];
#pragma unroll
    for (int e = 0; e < 8; ++e) { const int ch = nb * 64 + cg * 8 + e; cb[e] = a.in[5][ch];
#pragma unroll
        for (int j = 0; j < 4; ++j) cw[j][e] = a.in[4][j * 1024 + ch]; }
    if (tid < 64) CAR[tid] = 0.f;
    for (int t0 = 0; t0 < SEQ; t0 += LRU_T) {
#pragma unroll
        for (int h2 = 0; h2 < 2; ++h2) { const int t = ct + 64 * h2; float xc[8];
#pragma unroll
            for (int e = 0; e < 8; ++e) xc[e] = cb[e];
#pragma unroll
            for (int j = 0; j < 4; ++j) { const int tt = t0 + t - 3 + j;
                if (tt >= 0) { const u32x4 xv = *(const u32x4*)(XR + (size_t)tt * 1024 + cg * 8);
                    xc[0] += cw[j][0] * bflo(xv.x); xc[1] += cw[j][1] * bfhi(xv.x); xc[2] += cw[j][2] * bflo(xv.y); xc[3] += cw[j][3] * bfhi(xv.y);
                    xc[4] += cw[j][4] * bflo(xv.z); xc[5] += cw[j][5] * bfhi(xv.z); xc[6] += cw[j][6] * bflo(xv.w); xc[7] += cw[j][7] * bfhi(xv.w); } }
            *(LAS f32x4*)(U + t * LRU_US + cg * 8) = (f32x4){xc[0], xc[1], xc[2], xc[3]}; *(LAS f32x4*)(U + t * LRU_US + cg * 8 + 4) = (f32x4){xc[4], xc[5], xc[6], xc[7]};
            u32x4 w; w.x = pk2(xc[0], xc[1]); w.y = pk2(xc[2], xc[3]); w.z = pk2(xc[4], xc[5]); w.w = pk2(xc[6], xc[7]);
            *(LAS u32x4*)(lds + LRU_XB + t * 128 + 16 * (cg ^ ((t >> 1) & 7))) = w; }
        __syncthreads();
        { const int trow = 16 * wave + li; bf16x8 xa[2];
#pragma unroll
          for (int kc = 0; kc < 2; ++kc) xa[kc] = *(const LAS bf16x8*)(lds + LRU_XB + trow * 128 + 16 * ((kc * 4 + g4) ^ ((trow >> 1) & 7)));
#pragma unroll
          for (int nc = 0; nc < 4; ++nc) { f32x4 ar = {0.f, 0.f, 0.f, 0.f}, ai = ar;
#pragma unroll
              for (int kc = 0; kc < 2; ++kc) { ar = __builtin_amdgcn_mfma_f32_16x16x32_bf16(xa[kc], wf[nc][kc], ar, 0, 0, 0); ai = __builtin_amdgcn_mfma_f32_16x16x32_bf16(xa[kc], wf[nc + 4][kc], ai, 0, 0, 0); }
#pragma unroll
              for (int jj = 0; jj < 4; ++jj) { const int t = 16 * wave + 4 * g4 + jj, idx = t * LRU_US + nc * 16 + li;
                  const float rgate = fsigmoid(ar[jj] + br[nc]), igate = fsigmoid(ai[jj] + bi[nc]);
                  const float av = __expf(-sp[nc] * rgate); float mult = sqrtf(fmaxf(1.f - av * av, 0.f)); if (t0 + t == 0) mult = 1.f;
                  const float xcv = U[idx]; Aim[idx] = av; U[idx] = mult * igate * xcv; } } }
        __syncthreads();
        { const int c = tid & 63, sg = tid >> 6; float hl[16], pl[16]; float hcur = 0.f, pcur = 1.f;
          unsigned short grv[16];
#pragma unroll
          for (int k = 0; k < 16; ++k) grv[k] = GR[(size_t)(t0 + 16 * sg + k) * 1024 + c];
#pragma unroll
          for (int k = 0; k < 16; ++k) { const int idx = (16 * sg + k) * LRU_US + c; const float av = Aim[idx], uv = U[idx]; hcur = av * hcur + uv; pcur *= av; hl[k] = hcur; pl[k] = pcur; }
          SEG[(sg * 64 + c) * 2] = pcur; SEG[(sg * 64 + c) * 2 + 1] = hcur;
          __syncthreads();
          float hin = CAR[c];
          for (int s2 = 0; s2 < sg; ++s2) hin = SEG[(s2 * 64 + c) * 2] * hin + SEG[(s2 * 64 + c) * 2 + 1];
          __syncthreads();
#pragma unroll
          for (int k = 0; k < 16; ++k) { const float hv = hl[k] + pl[k] * hin; if (k == 15 && sg == 7) CAR[c] = hv;
              const float y = hv * __uint_as_float((unsigned)grv[k] << 16);
              YO[(size_t)(t0 + 16 * sg + k) * 1536 + c] = (bf16)(pk2(y, 0.f) & 0xffffu); } }
    }
    __syncthreads();
}


#ifndef NAIVE_ATTN
#define NAIVE_ATTN 0
#endif
#ifndef NAIVE_LRU
#define NAIVE_LRU 0
#endif
__device__ __forceinline__ void naive_attn(const Args& a, int lane, int wave) {
    bf16* QO = (bf16*)(a.ws + WS_Q); const bf16* Kg = (const bf16*)(a.ws + WS_K); const bf16* Vg = (const bf16*)(a.ws + WS_V); float* LSE = (float*)(a.ws + WS_LSE);
    const int gw = blockIdx.x * 8 + wave, NGW = gridDim.x * 8;
    for (int it = gw; it < M * 12; it += NGW) {
        const int m = it / 12, gh = it % 12, g = gh >> 2, dil = 1 << (2 * g);
        const int b = m / SEQ, t = m % SEQ;
        const int rres = t % dil, i = t / dil, qi = i & 127, n = i >> 7;
        const unsigned qv = *(const unsigned*)(QO + (size_t)m * AW + gh * 128 + 2 * lane);
        const float q0 = bflo(qv), q1 = bfhi(qv);
        float mx = -1e30f, den = 0.f, o0 = 0.f, o1 = 0.f;
        for (int kj = qi; kj <= qi + 128; ++kj) {
            if (n == 0 && kj < 128) continue;
            const int ii = (n - 1) * 128 + kj, tok = ii * dil + rres;
            const size_t off = ((size_t)b * SEQ + tok) * AW + gh * 128 + 2 * lane;
            const unsigned kv = *(const unsigned*)(Kg + off), vv = *(const unsigned*)(Vg + off);
            const float sc = wave_sum(q0 * bflo(kv) + q1 * bfhi(kv));
            const float nm = fmaxf(mx, sc), corr = __expf(mx - nm), p = __expf(sc - nm);
            den = den * corr + p; o0 = o0 * corr + p * bflo(vv); o1 = o1 * corr + p * bfhi(vv); mx = nm;
        }
        const float inv = 1.f / den;
        *(unsigned*)(QO + (size_t)m * AW + gh * 128 + 2 * lane) = pk2(o0 * inv, o1 * inv);
        if (lane == 0) LSE[(size_t)m * 12 + gh] = mx + __logf(den);
    }
}
__device__ __forceinline__ void naive_lru(LAS unsigned char* lds, const Args& a, int unit, int tid) {
    unsigned char* ws = a.ws;
    const int b = unit >> 4, nb = unit & 15; const size_t rowb = (size_t)b * SEQ;
    const bf16* XR = (const bf16*)(ws + WS_XR) + rowb * 1024 + nb * 64;
    const bf16* GR = (const bf16*)(ws + WS_GR) + rowb * 1024 + nb * 64;
    bf16* YO = (bf16*)a.out + rowb * 1536 + nb * 64;
    LAS float* xs = (LAS float*)lds;
    const int c = tid & 63, ch = nb * 64 + c;
    float h = 0.f;
    const float lam = a.in[10][ch]; const float sp = 8.f * (fmaxf(-lam, 0.f) + log1pf(expf(-fabsf(lam))));
    for (int t = 0; t < SEQ; ++t) {
        float xc = a.in[5][ch];
        for (int j = 0; j < 4; ++j) { const int tt = t - 3 + j; if (tt >= 0) xc += a.in[4][j * 1024 + ch] * __uint_as_float((unsigned)XR[(size_t)tt * 1024 + c] << 16); }
        __syncthreads();
        if (tid < 64) xs[c] = xc;
        __syncthreads();
        if (tid < 64) {
            float pr = a.in[7][ch], pi = a.in[9][ch];
            for (int k = 0; k < 64; ++k) { pr += xs[k] * a.in[6][(size_t)nb * 4096 + k * 64 + c]; pi += xs[k] * a.in[8][(size_t)nb * 4096 + k * 64 + c]; }
            const float rg = 1.f / (1.f + expf(-pr)), ig = 1.f / (1.f + expf(-pi));
            const float av = expf(-sp * rg); float mult = sqrtf(fmaxf(1.f - av * av, 0.f)); if (t == 0) mult = 1.f;
            h = av * h + mult * ig * xc;
            const float y = h * __uint_as_float((unsigned)GR[(size_t)t * 1024 + c] << 16);
            YO[(size_t)t * 1536 + c] = (bf16)(pk2(y, 0.f) & 0xffffu);
        }
    }
    __syncthreads();
}


#ifndef NAIVE_MASK
#define NAIVE_MASK 0x0
#endif
#define NV(k) ((NAIVE_MASK >> (k)) & 1)
__device__ __forceinline__ float bf2f(bf16 b) { return __uint_as_float((unsigned)b << 16); }
__device__ __forceinline__ bf16 f2bf(float f) { return (bf16)(pk2(f, 0.f) & 0xffffu); }
__device__ __forceinline__ float ndot(const bf16* arow, const float* W, int ldw, int col, int K) { float s = 0.f; for (int k = 0; k < K; ++k) s += bf2f(arow[k]) * W[(size_t)k * ldw + col]; return s; }
__device__ __forceinline__ void naive_p1(const Args& a) {
    unsigned char* ws = a.ws; const bf16* H = (const bf16*)(ws + WS_H);
    const size_t gt = (size_t)blockIdx.x * 512 + threadIdx.x, NT = (size_t)gridDim.x * 512;
    for (size_t i = gt; i < (size_t)M * NA; i += NT) { const int row = (int)(i / NA), col = (int)(i % NA);
        const float v = ndot(H + (size_t)row * D, a.in[3], INW, col, D);
        if (col < 1024) ((bf16*)(ws + WS_XR))[(size_t)row * 1024 + col] = f2bf(v);
        else if (col < 2048) { const float z = 0.7978845608028654f * (v + 0.044715f * v * v * v); ((bf16*)(ws + WS_GR))[(size_t)row * 1024 + col - 1024] = f2bf(0.5f * v * (1.f + tanhf(z))); }
        else if (col < 3584) ((bf16*)(ws + WS_Q))[(size_t)row * AW + col - 2048] = f2bf(v);
        else if (col < 5120) ((bf16*)(ws + WS_K))[(size_t)row * AW + col - 3584] = f2bf(v);
        else ((bf16*)(ws + WS_V))[(size_t)row * AW + col - 5120] = f2bf(v); }
}
__device__ __forceinline__ void naive_rope(const Args& a) {
    unsigned char* ws = a.ws; const int* pos = (const int*)a.in[1];
    const size_t gt = (size_t)blockIdx.x * 512 + threadIdx.x, NT = (size_t)gridDim.x * 512;
    for (size_t i = gt; i < (size_t)M * 24; i += NT) { const int row = (int)(i / 24), r = (int)(i % 24), which = r / 12, head = r % 12;
        bf16* p = (bf16*)(ws + (which ? WS_K : WS_Q)) + (size_t)row * AW + head * 128;
        for (int f = 0; f < 16; ++f) { const float ang = (float)pos[row] * a.invf[f]; const double ad = (double)ang; const float c = (float)cos(ad), sn = (float)sin(ad);
            const float t1 = bf2f(p[f]), t2 = bf2f(p[16 + f]); p[f] = f2bf(t1 * c - t2 * sn); p[16 + f] = f2bf(t2 * c + t1 * sn); }
        if (!which) for (int d = 0; d < 128; ++d) p[d] = f2bf(bf2f(p[d]) * 0.08838834764831845f); }
}
__device__ __forceinline__ void naive_p3(const Args& a) {
    unsigned char* ws = a.ws; const bf16* H = (const bf16*)(ws + WS_H);
    const size_t gt = (size_t)blockIdx.x * 512 + threadIdx.x, NT = (size_t)gridDim.x * 512;
    for (size_t i = gt; i < (size_t)M * NGATE; i += NT) { const int row = (int)(i / NGATE), col = (int)(i % NGATE);
        const bf16* wt = (const bf16*)(ws + WS_WGT) + (size_t)col * D; float v = 0.f; for (int k = 0; k < D; ++k) v += bf2f(H[(size_t)row * D + k]) * bf2f(wt[k]);
        ((bf16*)(ws + WS_GATES))[i] = f2bf(1.f / (1.f + expf(-v))); }
}
__device__ __forceinline__ void naive_p4(const Args& a) {
    unsigned char* ws = a.ws; const bf16* YO = (const bf16*)a.out; const bf16* G = (const bf16*)(ws + WS_GATES);
    const size_t gt = (size_t)blockIdx.x * 512 + threadIdx.x, NT = (size_t)gridDim.x * 512;
    for (size_t i = gt; i < (size_t)M * D; i += NT) { const int row = (int)(i / D), col = (int)(i % D);
        const float s1 = ndot(YO + (size_t)row * 1536, a.in[11], D, col, 1024), s2 = ndot(YO + (size_t)row * 1536 + 1024, a.in[12], D, col, 512);
        ((bf16*)(ws + WS_MIXIN))[i] = f2bf(bf2f(G[(size_t)row * 2048 + col]) * s1 + bf2f(G[(size_t)row * 2048 + 1024 + col]) * s2); }
}
__device__ __forceinline__ void naive_sq(const Args& a, const bf16* A, int K, const float* W, bf16* O, float* rsq) {
    const size_t gt = (size_t)blockIdx.x * 512 + threadIdx.x, NT = (size_t)gridDim.x * 512;
    for (size_t i = gt; i < (size_t)M * D; i += NT) { const int row = (int)(i / D), col = (int)(i % D);
        const float v = ndot(A + (size_t)row * K, W, D, col, K); O[i] = f2bf(v); atomicAdd(rsq + row, v * v); }
}
__device__ __forceinline__ void naive_p7(const Args& a) {
    unsigned char* ws = a.ws; const bf16* H2 = (const bf16*)(ws + WS_H2);
    const size_t gt = (size_t)blockIdx.x * 512 + threadIdx.x, NT = (size_t)gridDim.x * 512;
    for (size_t i = gt; i < (size_t)M * DFF; i += NT) { const int row = (int)(i / DFF), col = (int)(i % DFF);
        const float gq = ndot(H2 + (size_t)row * D, a.in[16], DFF, col, D), up = ndot(H2 + (size_t)row * D, a.in[17], DFF, col, D);
        ((bf16*)(ws + WS_ACT))[i] = f2bf(gq / (1.f + expf(-gq)) * up); }
}

__device__ __forceinline__ void combine_rows(const Args& a, int lane, int wave) {
    const bf16* O = (const bf16*)(a.ws + WS_Q); const float* LSE = (const float*)(a.ws + WS_LSE); bf16* YO = (bf16*)a.out;
    const int gw = blockIdx.x * 8 + wave, NGW = gridDim.x * 8, hh = lane >> 4;
    for (int m = gw; m < M; m += NGW) {
        const float l0 = LSE[(size_t)m * 12 + hh], l1 = LSE[(size_t)m * 12 + 4 + hh], l2 = LSE[(size_t)m * 12 + 8 + hh];
        const float mx = fmaxf(l0, fmaxf(l1, l2)); float w0 = __expf(l0 - mx), w1 = __expf(l1 - mx), w2 = __expf(l2 - mx); const float inv = frcp(w0 + w1 + w2); w0 *= inv; w1 *= inv; w2 *= inv;
        const bf16* op = O + (size_t)m * AW + lane * 8; const u32x4 a0 = *(const u32x4*)op, a1 = *(const u32x4*)(op + 512), a2 = *(const u32x4*)(op + 1024);
        u32x4 w;
        w.x = pk2(w0 * bflo(a0.x) + w1 * bflo(a1.x) + w2 * bflo(a2.x), w0 * bfhi(a0.x) + w1 * bfhi(a1.x) + w2 * bfhi(a2.x));
        w.y = pk2(w0 * bflo(a0.y) + w1 * bflo(a1.y) + w2 * bflo(a2.y), w0 * bfhi(a0.y) + w1 * bfhi(a1.y) + w2 * bfhi(a2.y));
        w.z = pk2(w0 * bflo(a0.z) + w1 * bflo(a1.z) + w2 * bflo(a2.z), w0 * bfhi(a0.z) + w1 * bfhi(a1.z) + w2 * bfhi(a2.z));
        w.w = pk2(w0 * bflo(a0.w) + w1 * bflo(a1.w) + w2 * bflo(a2.w), w0 * bfhi(a0.w) + w1 * bfhi(a1.w) + w2 * bfhi(a2.w));
        *(u32x4*)(YO + (size_t)m * 1536 + 1024 + lane * 8) = w;
    }
}

__device__ __forceinline__ void rows_mid(const Args& a, int lane, int wave) {
    const bf16* MIX = (const bf16*)(a.ws + WS_MIX); const float* rsq = (const float*)(a.ws + WS_RSQ1); bf16* H2 = (bf16*)(a.ws + WS_H2);
    const int gw = blockIdx.x * 8 + wave, NGW = gridDim.x * 8;
    f32x4 g1[4], g2[4];
#pragma unroll
    for (int j = 0; j < 4; ++j) { g1[j] = *((const f32x4*)a.in[14] + lane + 64 * j); g2[j] = *((const f32x4*)a.in[15] + lane + 64 * j); }
    for (int m = gw; m < M; m += NGW) {
        const float rstd1 = rsqrtf(rsq[m] * (1.f / D) + EPS);
        const f32x4* xr = (const f32x4*)(a.in[0] + (size_t)m * D) + lane; const u32x2* mr = (const u32x2*)(MIX + (size_t)m * D) + lane; f32x4* xo = (f32x4*)(a.out + (size_t)m * D) + lane;
        f32x4 v[4]; float s = 0.f;
#pragma unroll
        for (int j = 0; j < 4; ++j) { const f32x4 xv = xr[64 * j]; const u32x2 mv = mr[64 * j]; const f32x4 mf = {bflo(mv.x), bfhi(mv.x), bflo(mv.y), bfhi(mv.y)};
            v[j] = xv + mf * rstd1 * g1[j]; xo[64 * j] = v[j]; s += (v[j].x * v[j].x + v[j].y * v[j].y) + (v[j].z * v[j].z + v[j].w * v[j].w); }
        const float rstd2 = rsqrtf(wave_sum(s) * (1.f / D) + EPS);
        u32x2* o8 = (u32x2*)(H2 + (size_t)m * D) + lane;
#pragma unroll
        for (int j = 0; j < 4; ++j) { const f32x4 t = v[j] * rstd2 * g2[j]; u32x2 w; w.x = pk2(t.x, t.y); w.y = pk2(t.z, t.w); o8[64 * j] = w; }
    }
}
__device__ __forceinline__ void rows_final(const Args& a, int lane, int wave) {
    const bf16* F = (const bf16*)(a.ws + WS_F); const float* rsq = (const float*)(a.ws + WS_RSQ2);
    const int gw = blockIdx.x * 8 + wave, NGW = gridDim.x * 8;
    f32x4 g1[4];
#pragma unroll
    for (int j = 0; j < 4; ++j) g1[j] = *((const f32x4*)a.in[19] + lane + 64 * j);
    for (int m = gw; m < M; m += NGW) {
        const float rstd = rsqrtf(rsq[m] * (1.f / D) + EPS);
        const u32x2* fr_ = (const u32x2*)(F + (size_t)m * D) + lane; f32x4* xo = (f32x4*)(a.out + (size_t)m * D) + lane;
#pragma unroll
        for (int j = 0; j < 4; ++j) { const f32x4 xv = xo[64 * j]; const u32x2 mv = fr_[64 * j]; const f32x4 mf = {bflo(mv.x), bfhi(mv.x), bflo(mv.y), bfhi(mv.y)}; xo[64 * j] = xv + mf * rstd * g1[j]; }
    }
}

__global__ void __launch_bounds__(512, 2) hawk_fwd(Args a) {
    extern __shared__ __attribute__((aligned(16))) unsigned char lds_raw[];
    LAS unsigned char* lds = (LAS unsigned char*)lds_raw;
    const int tid = threadIdx.x, lane = tid & 63, wave = __builtin_amdgcn_readfirstlane(tid >> 6);
    const int G = gridDim.x, bx = blockIdx.x;
    unsigned char* ws = a.ws;
    const int lo = a.ph_lo, hi = a.ph_hi;
#ifndef PMASK
#define PMASK 0x7ff
#endif
#define IN(k) (((PMASK >> (k)) & 1) && lo <= (k) && (k) < hi)
#if MK_MULTI
#define SEAM(k) do { } while (0)
#else
    cg::grid_group grid = cg::this_grid();
#define SEAM(k) do { if (IN(k) && IN((k) + 1)) grid.sync(); } while (0)
#endif
    typedef pg8::StaticOrder SO;
    if (IN(0)) { p0_prologue(a, lds, tid, lane, wave); __syncthreads(); }
    SEAM(0);
    if (IN(1) && NV(1)) naive_p1(a);
    if (IN(1) && !NV(1)) { pg8::Gemm g{(const bf16*)(ws + WS_H), (const bf16*)(ws + WS_WIN), M, NA, D}; SO S; S.init(M, NA, G, bx);
        EpiProj E{(bf16*)(ws + WS_XR), (bf16*)(ws + WS_GR), (bf16*)(ws + WS_Q), (bf16*)(ws + WS_K), (bf16*)(ws + WS_V), (const float*)(ws + WS_ROPE)};
        pg8::gemm_phase<EpiProj, SO, PG8_ALIGN, PG8_SP2>(lds, g, S, E); }
    SEAM(1);
    if (IN(2) && NV(1)) { naive_rope(a); __syncthreads(); }
    if (IN(2)) {
#if NAIVE_ATTN
        naive_attn(a, lane, wave);
#else
        for (int u = bx; u < BATCH * 12 * 16; u += G) attn_unit(lds, (bf16*)(ws + WS_Q), (const bf16*)(ws + WS_K), (const bf16*)(ws + WS_V), (float*)(ws + WS_LSE), u, tid, wave, lane);
#endif
#if NAIVE_LRU
        for (int u = bx; u < BATCH * 16; u += G) naive_lru(lds, a, u, tid);
#else
        for (int u = bx; u < BATCH * 16; u += G) lru_unit(lds, a, u, tid, wave, lane);
#endif
    }
    SEAM(2);
    if (IN(3)) combine_rows(a, lane, wave);
    SEAM(3);
    if (IN(4) && NV(3)) naive_p3(a);
    if (IN(4) && !NV(3)) {
        pg8::Gemm g{(const bf16*)(ws + WS_H), (const bf16*)(ws + WS_WGT), M, NGATE, D}; SO S; S.init(M, NGATE, G, bx);
        EpiSigmoid E{(bf16*)(ws + WS_GATES), NGATE};
        pg8::gemm_phase<EpiSigmoid, SO, PG8_ALIGN, PG8_SP2>(lds, g, S, E); }
    SEAM(4);
    if (IN(5) && NV(4)) naive_p4(a);
    if (IN(5) && !NV(4)) { pg8::Gemm g{(const bf16*)a.out, (const bf16*)(ws + WS_WLA), M, D, 1536}; SO S; S.init(M, D, G, bx);
        EpiMerge E{(const bf16*)(ws + WS_GATES), (bf16*)(ws + WS_MIXIN)};
        pg8::gemm_phase<EpiMerge, SO, PG8_ALIGN, PG8_SP2>(lds, g, S, E); }
    SEAM(5);
    if (IN(6) && NV(5)) naive_sq(a, (const bf16*)(ws + WS_MIXIN), D, a.in[13], (bf16*)(ws + WS_MIX), (float*)(ws + WS_RSQ1));
    if (IN(6) && !NV(5)) { pg8::Gemm g{(const bf16*)(ws + WS_MIXIN), (const bf16*)(ws + WS_WOUT), M, D, D}; SO S; S.init(M, D, G, bx);
        EpiSq E{(bf16*)(ws + WS_MIX), (float*)(ws + WS_RSQ1)};
        pg8::gemm_phase<EpiSq, SO, PG8_ALIGN, PG8_SP2>(lds, g, S, E); }
    SEAM(6);
    if (IN(7)) rows_mid(a, lane, wave);
    SEAM(7);
    if (IN(8) && NV(7)) naive_p7(a);
    if (IN(8) && !NV(7)) { pg8::Gemm g{(const bf16*)(ws + WS_H2), (const bf16*)(ws + WS_WGU), M, 2 * DFF, D}; SO S; S.init(M, 2 * DFF, G, bx);
        EpiSwiglu E{(bf16*)(ws + WS_ACT)};
        pg8::gemm_phase<EpiSwiglu, SO, PG8_ALIGN, PG8_SP2>(lds, g, S, E); }
    SEAM(8);
    if (IN(9) && NV(8)) naive_sq(a, (const bf16*)(ws + WS_ACT), DFF, a.in[18], (bf16*)(ws + WS_F), (float*)(ws + WS_RSQ2));
    if (IN(9) && !NV(8)) { pg8::Gemm g{(const bf16*)(ws + WS_ACT), (const bf16*)(ws + WS_WD), M, D, DFF}; SO S; S.init(M, D, G, bx);
        EpiSq E{(bf16*)(ws + WS_F), (float*)(ws + WS_RSQ2)};
        pg8::gemm_phase<EpiSq, SO, PG8_ALIGN, PG8_SP2>(lds, g, S, E); }
    SEAM(9);
    if (IN(10)) rows_final(a, lane, wave);
#undef IN
#undef SEAM
}

extern "C" void kernel_launch(void* const* d_in, const int* in_sizes, int n_in, void* d_out, int out_size, void* d_ws, size_t ws_size, hipStream_t stream) {
    static int grid = 0;
    if (grid == 0) {
        if (n_in != 20 || in_sizes[0] != M * D || out_size != M * D || ws_size < WS_END) { fprintf(stderr, "kernel_launch: unexpected shapes (n_in %d, in0 %d, out %d, ws %zu); nothing launched\n", n_in, n_in > 0 ? in_sizes[0] : -1, out_size, ws_size); grid = -1; return; }
        int dev = 0, cus = 0, per_cu = 0;
        if (hipGetDevice(&dev) != hipSuccess || hipDeviceGetAttribute(&cus, hipDeviceAttributeMultiprocessorCount, dev) != hipSuccess) { grid = -1; return; }
        if (hipFuncSetAttribute((const void*)hawk_fwd, hipFuncAttributeMaxDynamicSharedMemorySize, LDS_BYTES) != hipSuccess) { fprintf(stderr, "kernel_launch: hipFuncSetAttribute failed\n"); grid = -1; return; }
        if (hipOccupancyMaxActiveBlocksPerMultiprocessor(&per_cu, (const void*)hawk_fwd, 512, LDS_BYTES) != hipSuccess || per_cu < 1) { fprintf(stderr, "kernel_launch: occupancy query says %d blocks per CU\n", per_cu); per_cu = 1; }
        (void)hipGetLastError();
        grid = cus * per_cu;
    }
    if (grid < 0) return;
    Args a{};
    for (int i = 0; i < 20; ++i) a.in[i] = (const float*)d_in[i];
    a.out = (float*)d_out; a.ws = (unsigned char*)d_ws;
    for (int i = 0; i < 16; ++i) a.invf[i] = (float)pow(500000.0, -(double)(2 * i) / 32.0);
#if MK_MULTI
    for (int p = 0; p < NPHASE; ++p) { a.ph_lo = p; a.ph_hi = p + 1; hipLaunchKernelGGL(hawk_fwd, dim3(grid), dim3(512), LDS_BYTES, stream, a); }
#else
    a.ph_lo = 0; a.ph_hi = NPHASE;
    void* args[] = {&a};
    hipError_t e = hipLaunchCooperativeKernel((const void*)hawk_fwd, dim3(grid), dim3(512), args, LDS_BYTES, stream);
    if (e != hipSuccess) fprintf(stderr, "cooperative launch failed: %s (grid %d)\n", hipGetErrorString(e), grid);
#endif
}
```
